# Optimizing an MI355X kernel written in HIP

```python
import jax, jax.numpy as jnp
from jax import lax
import numpy as np

D_MODEL = 1024
BATCH = 8
SEQ = 2048
DEPTH = 1

N_MEM = 256
NORM_EPS = 1e-6
NEG_INF = -1e30

MIX_WIDTH = D_MODEL
MOBA_WIDTH = MIX_WIDTH // 2
RET_WIDTH = MIX_WIDTH - MOBA_WIDTH

MOBA_HEAD_DIM = 64
MOBA_HEADS = MOBA_WIDTH // MOBA_HEAD_DIM
MOBA_BLOCK = 256
MOBA_TOPK = 3
MOBA_Q_BLOCK = 32
ROPE_THETA = 500000.0
ROPE_DIM = MOBA_HEAD_DIM // 4

RET_HEADS = 4
RET_V_DIM = RET_WIDTH // RET_HEADS
RET_QK_DIM = RET_V_DIM // 2
RET_CHUNK = 128
RET_THETA = 10000.0

CROSS_HEADS = 4
CROSS_HEAD_DIM = D_MODEL // CROSS_HEADS

D_FF = -(-8 * D_MODEL // (3 * 256)) * 256

W_MQ = MOBA_WIDTH
W_MK = MOBA_WIDTH
W_MV = MOBA_WIDTH
W_RQ = RET_HEADS * RET_QK_DIM
W_RK = RET_HEADS * RET_QK_DIM
W_RV = RET_WIDTH
W_RG = RET_WIDTH
IN_PROJ_WIDTH = W_MQ + W_MK + W_MV + W_RQ + W_RK + W_RV + W_RG
SPLIT_POINTS = [W_MQ, W_MQ + W_MK, W_MQ + W_MK + W_MV,
                W_MQ + W_MK + W_MV + W_RQ,
                W_MQ + W_MK + W_MV + W_RQ + W_RK,
                W_MQ + W_MK + W_MV + W_RQ + W_RK + W_RV]

kernel_name = "hymba_moba_retnet_sandwich_layer"


def rms_norm(x, g):
    xf = x.astype(jnp.float32)
    y = xf * lax.rsqrt(jnp.mean(xf * xf, axis=-1, keepdims=True) + NORM_EPS)
    return (y * g.astype(jnp.float32)).astype(x.dtype)


def rotary(x, inv_freq, rot_dim):
    S = x.shape[2]
    half = rot_dim // 2
    ang = jnp.arange(S, dtype=jnp.float32)[:, None] * inv_freq[None, :]
    cos, sin = jnp.cos(ang), jnp.sin(ang)
    xr = x[..., :rot_dim].astype(jnp.float32)
    x1, x2 = xr[..., :half], xr[..., half:]
    rot = jnp.concatenate([x1 * cos - x2 * sin, x2 * cos + x1 * sin], axis=-1).astype(x.dtype)
    return jnp.concatenate([rot, x[..., rot_dim:]], axis=-1)


def split_heads(t, n_heads):
    B, S, _ = t.shape
    return t.reshape(B, S, n_heads, -1).transpose(0, 2, 1, 3)


def merge_heads(t):
    B, H, S, d = t.shape
    return t.transpose(0, 2, 1, 3).reshape(B, S, H * d)


def moba_attention(q, k, v):
    B, H, S, dh = q.shape
    L = MOBA_BLOCK
    nb = -(-S // L)
    pad = nb * L - S
    kp = jnp.pad(k, ((0, 0), (0, 0), (0, pad), (0, 0)))
    vp = jnp.pad(v, ((0, 0), (0, 0), (0, pad), (0, 0)))
    k_blocks = kp.reshape(B, H, nb, L, dh)
    v_blocks = vp.reshape(B, H, nb, L, dh)
    k_mean = jnp.mean(k_blocks.astype(jnp.float32), axis=3).astype(q.dtype)
    n_sel = min(MOBA_TOPK, nb)
    scale = dh ** -0.5
    QB = MOBA_Q_BLOCK
    nq = S // QB
    q_blocks = q.reshape(B, H, nq, QB, dh).transpose(2, 0, 1, 3, 4)
    b_idx = jnp.arange(B)[:, None, None, None]
    h_idx = jnp.arange(H)[None, :, None, None]
    block_ids = jnp.arange(nb)
    slot_ids = jnp.arange(n_sel)
    key_offsets = jnp.arange(L)

    def one_query_block(args):
        qb, qi = args
        q_pos = qi * QB + jnp.arange(QB)
        cur = (qi * QB) // L
        gate = jnp.einsum('bhqd,bhnd->bhqn', qb, k_mean).astype(jnp.float32)
        gate = jnp.where((block_ids < cur)[None, None, None, :], gate, NEG_INF)
        _, sel = lax.top_k(gate, n_sel)
        slot_valid = slot_ids < cur
        k_sel = k_blocks[b_idx, h_idx, sel]
        v_sel = v_blocks[b_idx, h_idx, sel]
        s_sel = jnp.einsum('bhqd,bhqnld->bhqnl', qb, k_sel).astype(jnp.float32) * scale
        s_sel = jnp.where(slot_valid[:, None], s_sel, NEG_INF)
        k_own = lax.dynamic_index_in_dim(k_blocks, cur, axis=2, keepdims=False)
        v_own = lax.dynamic_index_in_dim(v_blocks, cur, axis=2, keepdims=False)
        s_own = jnp.einsum('bhqd,bhld->bhql', qb, k_own).astype(jnp.float32) * scale
        own_pos = cur * L + key_offsets
        s_own = jnp.where(own_pos[None, :] <= q_pos[:, None], s_own, NEG_INF)
        logits = jnp.concatenate([s_sel.reshape(B, H, QB, n_sel * L), s_own], axis=-1)
        p = jax.nn.softmax(logits, axis=-1)
        p_sel = p[..., :n_sel * L].reshape(B, H, QB, n_sel, L).astype(v.dtype)
        p_own = p[..., n_sel * L:].astype(v.dtype)
        return (jnp.einsum('bhqnl,bhqnld->bhqd', p_sel, v_sel)
                + jnp.einsum('bhql,bhld->bhqd', p_own, v_own))

    out = lax.map(one_query_block, (q_blocks, jnp.arange(nq)))
    return out.transpose(1, 2, 0, 3, 4).reshape(B, H, S, dh)


def retention(q, k, v):
    B, H, S, dk = q.shape
    dv = v.shape[-1]
    C = RET_CHUNK
    nc = S // C
    log_g = jnp.log(1.0 - jnp.power(2.0, -5.0 - jnp.arange(H, dtype=jnp.float32)))
    idx = jnp.arange(C, dtype=jnp.float32)
    diff = idx[:, None] - idx[None, :]
    inner_decay = jnp.where(diff >= 0, jnp.exp(log_g[:, None, None] * jnp.maximum(diff, 0.0)), 0.0)
    q_decay = jnp.exp(log_g[:, None] * (idx + 1.0))[None, :, :, None]
    k_decay = jnp.exp(log_g[:, None] * (C - 1.0 - idx))[None, :, :, None]
    chunk_decay = jnp.exp(log_g * C)[None, :, None, None]

    def to_chunks(t):
        return t.astype(jnp.float32).reshape(B, H, nc, C, t.shape[-1]).transpose(2, 0, 1, 3, 4)

    def step(state, inp):
        qc, kc, vc = inp
        attn = jnp.einsum('bhid,bhjd->bhij', qc, kc) * inner_decay[None]
        inner = jnp.einsum('bhij,bhjv->bhiv', attn, vc)
        cross = jnp.einsum('bhid,bhdv->bhiv', qc * q_decay, state)
        new_state = state * chunk_decay + jnp.einsum('bhjd,bhjv->bhdv', kc * k_decay, vc)
        return new_state, inner + cross

    state0 = jnp.zeros((B, H, dk, dv), jnp.float32)
    _, out = lax.scan(step, state0, (to_chunks(q), to_chunks(k), to_chunks(v)))
    return out.transpose(1, 2, 0, 3, 4).reshape(B, H, S, dv)


def cross_attention(h, mem_n, w_cq, w_ckv, w_co):
    q = split_heads(h @ w_cq, CROSS_HEADS)
    kv = mem_n @ w_ckv
    k = split_heads(kv[..., :D_MODEL], CROSS_HEADS)
    v = split_heads(kv[..., D_MODEL:], CROSS_HEADS)
    s = jnp.einsum('bhsd,bhmd->bhsm', q, k).astype(jnp.float32) * (CROSS_HEAD_DIM ** -0.5)
    p = jax.nn.softmax(s, axis=-1).astype(v.dtype)
    o = jnp.einsum('bhsm,bhmd->bhsd', p, v)
    return merge_heads(o) @ w_co


def setup_inputs(seed: int = 0) -> dict:
    key = jax.random.key(seed)
    ks = jax.random.split(key, 16)

    def w(k, shape, fan_in):
        return jax.random.normal(k, shape, jnp.float32) * (fan_in ** -0.5)

    def gain(k):
        return 1.0 + 0.05 * jax.random.normal(k, (DEPTH, D_MODEL), jnp.float32)

    return {
        "x": jax.random.normal(ks[0], (BATCH, SEQ, D_MODEL), jnp.float32),
        "mem": jax.random.normal(ks[1], (BATCH, N_MEM, D_MODEL), jnp.float32),
        "g_pre_mix": gain(ks[2]),
        "w_in": w(ks[3], (DEPTH, D_MODEL, IN_PROJ_WIDTH), D_MODEL),
        "w_out": w(ks[4], (DEPTH, MIX_WIDTH, D_MODEL), MIX_WIDTH),
        "g_post_mix": gain(ks[5]),
        "g_pre_cross": gain(ks[6]),
        "g_mem": gain(ks[7]),
        "w_cq": w(ks[8], (DEPTH, D_MODEL, D_MODEL), D_MODEL),
        "w_ckv": w(ks[9], (DEPTH, D_MODEL, 2 * D_MODEL), D_MODEL),
        "w_co": w(ks[10], (DEPTH, D_MODEL, D_MODEL), D_MODEL),
        "g_post_cross": gain(ks[11]),
        "g_pre_ffn": gain(ks[12]),
        "w_gate_up": w(ks[13], (DEPTH, D_MODEL, 2 * D_FF), D_MODEL),
        "w_down": w(ks[14], (DEPTH, D_FF, D_MODEL), D_FF),
        "g_post_ffn": gain(ks[15]),
    }


def reference(x, mem, g_pre_mix, w_in, w_out, g_post_mix, g_pre_cross, g_mem, w_cq, w_ckv,
              w_co, g_post_cross, g_pre_ffn, w_gate_up, w_down, g_post_ffn):
    moba_inv = jnp.power(ROPE_THETA, -jnp.arange(ROPE_DIM // 2, dtype=jnp.float32) * 2.0 / ROPE_DIM)
    ret_inv = 1.0 / jnp.power(RET_THETA, jnp.linspace(0.0, 1.0, RET_QK_DIM // 2, dtype=jnp.float32))
    for l in range(DEPTH):
        h = rms_norm(x, g_pre_mix[l])
        proj = h @ w_in[l]
        mq, mk, mv, rq, rk, rv, rg = jnp.split(proj, SPLIT_POINTS, axis=-1)
        mq = rotary(split_heads(mq, MOBA_HEADS), moba_inv, ROPE_DIM)
        mk = rotary(split_heads(mk, MOBA_HEADS), moba_inv, ROPE_DIM)
        mo = merge_heads(moba_attention(mq, mk, split_heads(mv, MOBA_HEADS)))
        rq = rotary(split_heads(rq, RET_HEADS), ret_inv, RET_QK_DIM)
        rk = rotary(split_heads(rk, RET_HEADS), ret_inv, RET_QK_DIM) * (RET_QK_DIM ** -0.5)
        ro = retention(rq, rk, split_heads(rv, RET_HEADS))
        ro = ro * lax.rsqrt(jnp.mean(ro * ro, axis=-1, keepdims=True) + NORM_EPS)
        ro = jax.nn.silu(rg) * merge_heads(ro).astype(x.dtype)
        mix = jnp.concatenate([mo, ro], axis=-1) @ w_out[l]
        x = x + rms_norm(mix, g_post_mix[l])
        h = rms_norm(x, g_pre_cross[l])
        mem_n = rms_norm(mem, g_mem[l])
        c = cross_attention(h, mem_n, w_cq[l], w_ckv[l], w_co[l])
        x = x + rms_norm(c, g_post_cross[l])
        h = rms_norm(x, g_pre_ffn[l])
        gu = h @ w_gate_up[l]
        f = (jax.nn.silu(gu[..., :D_FF]) * gu[..., D_FF:]) @ w_down[l]
        x = x + rms_norm(f, g_post_ffn[l])
    return x
```

```cpp
#include <hip/hip_runtime.h>
#include <cstdint>
#include <cstdio>

typedef unsigned short bf16;
typedef unsigned u32x4 __attribute__((ext_vector_type(4)));
typedef float f32x4 __attribute__((ext_vector_type(4)));

constexpr int BATCH = 8, SEQ = 2048, D = 1024, M = BATCH * SEQ;
constexpr int NMEM = 256, MM = BATCH * NMEM;
constexpr int NPROJ = 3072, DFF = 2816, NGU = 2 * DFF;
constexpr float EPS = 1e-6f;
constexpr float LOG2E = 1.4426950408889634f;
constexpr float C2M = 0.125f * LOG2E;
constexpr float C2X = 0.0625f * LOG2E;

constexpr size_t MiB = 1u << 20;
constexpr size_t WS_CTL = 0;
constexpr size_t WS_ROTM = 1 * MiB;
constexpr size_t WS_ROTR = 1 * MiB + 256 * 1024;
constexpr size_t WS_KMEAN = 1 * MiB + 768 * 1024;
constexpr size_t WS_WIN = 2 * MiB, WS_WOUT = 8 * MiB, WS_WCQ = 10 * MiB, WS_WCK = 12 * MiB, WS_WCV = 14 * MiB, WS_WCO = 16 * MiB, WS_WGU = 18 * MiB, WS_WDN = 29 * MiB;
constexpr size_t WS_MEMN = 35 * MiB, WS_CK = 39 * MiB, WS_CVT = 43 * MiB;
constexpr size_t WS_XN = 48 * MiB, WS_MIX = 80 * MiB;
constexpr size_t WS_A = 112 * MiB;
constexpr size_t WS_PROJ = WS_A, WS_CQ = WS_A, WS_PBUF = WS_A + 32 * MiB, WS_CO = WS_A + 64 * MiB, WS_F = WS_A;
constexpr size_t WS_END = 212 * MiB;

__device__ __forceinline__ unsigned f2bf(float f) { unsigned u = __builtin_bit_cast(unsigned, f); return (u + 0x7fffu + ((u >> 16) & 1u)) >> 16; }
__device__ __forceinline__ float bf2f(unsigned h) { return __builtin_bit_cast(float, h << 16); }
__device__ __forceinline__ unsigned pk2(float lo, float hi) { return f2bf(lo) | (f2bf(hi) << 16); }
__device__ __forceinline__ float wave_sum(float v) {
#pragma unroll
    for (int o = 1; o < 64; o <<= 1) v += __shfl_xor(v, o);
    return v;
}
__device__ __forceinline__ float wave_max(float v) {
#pragma unroll
    for (int o = 1; o < 64; o <<= 1) v = fmaxf(v, __shfl_xor(v, o));
    return v;
}
__device__ __forceinline__ float siluf(float x) { return x / (1.f + __expf(-x)); }

__global__ void k_tables(float2* rotm, float2* rotr) {
    const int t = blockIdx.x * blockDim.x + threadIdx.x;
    if (t < SEQ * 8) { const int s = t / 8, i = t % 8; const float inv = (float)pow(500000.0, -(double)i / 8.0); const float a = (float)s * inv; rotm[t] = make_float2((float)cos((double)a), (float)sin((double)a)); }
    if (t < SEQ * 32) { const int s = t / 32, i = t % 32; const float inv = (float)(1.0 / pow(10000.0, (double)i / 31.0)); const float a = (float)s * inv; rotr[t] = make_float2((float)cos((double)a), (float)sin((double)a)); }
}
enum { MAP_ID = 0, MAP_INPROJ = 1, MAP_GU = 2 };
__device__ __forceinline__ int src_col(int r, int mode, int off) {
    if (mode == MAP_INPROJ) {
        if (r < 1024) { const int d = r & 63; if (d < 16) return (r & ~63) + (d >> 1) + 8 * (d & 1); return r; }
        if (r >= 1536 && r < 2048) { const int d = r & 63; return (r & ~63) + (d >> 1) + 32 * (d & 1); }
        return r;
    }
    if (mode == MAP_GU) { const int t = r >> 8, w = r & 255; return (w < 128) ? (128 * t + w) : (DFF + 128 * t + (w - 128)); }
    return r + off;
}
__global__ void k_convert_w(const float* __restrict__ W, bf16* __restrict__ WT, const float* __restrict__ gain, int K, int N, int mode, int off) {
    __shared__ float t[32][33];
    const int r0 = blockIdx.x * 32, k0 = blockIdx.y * 32, tx = threadIdx.x, ty = threadIdx.y;
    const int sc = src_col(r0 + tx, mode, off);
    for (int i = ty; i < 32; i += 8) { const int k = k0 + i; t[i][tx] = W[(size_t)k * N + sc] * (gain ? gain[k] : 1.f); }
    __syncthreads();
    for (int i = ty; i < 32; i += 8) WT[(size_t)(r0 + i) * K + k0 + tx] = (bf16)f2bf(t[tx][i]);
}
__global__ void k_rmsnorm_bf16(const float* __restrict__ x, bf16* __restrict__ o, int rows, int pad_) {
    const int row = blockIdx.x * 4 + (threadIdx.x >> 6), lane = threadIdx.x & 63;
    if (row >= rows) return;
    const f32x4* xr = (const f32x4*)(x + (size_t)row * D) + lane;
    f32x4 v[4]; float s = 0.f;
#pragma unroll
    for (int j = 0; j < 4; ++j) { v[j] = xr[64 * j]; s += v[j].x * v[j].x + v[j].y * v[j].y + v[j].z * v[j].z + v[j].w * v[j].w; }
    const float rstd = 1.f / sqrtf(wave_sum(s) * (1.f / D) + EPS);
    unsigned long long* o8 = (unsigned long long*)(o + (size_t)row * D) + lane;
#pragma unroll
    for (int j = 0; j < 4; ++j) o8[64 * j] = (unsigned long long)pk2(v[j].x * rstd, v[j].y * rstd) | ((unsigned long long)pk2(v[j].z * rstd, v[j].w * rstd) << 32);
}
__global__ void k_postnorm(const float* __restrict__ t, const float* xi, const float* __restrict__ g, float* xo, bf16* __restrict__ xn, int rows, int pad_) {
    const int row = blockIdx.x * 4 + (threadIdx.x >> 6), lane = threadIdx.x & 63;
    if (row >= rows) return;
    const f32x4* tr = (const f32x4*)(t + (size_t)row * D) + lane;
    const f32x4* xr = (const f32x4*)(xi + (size_t)row * D) + lane;
    const f32x4* gr = (const f32x4*)g + lane;
    f32x4 v[4]; float s = 0.f;
#pragma unroll
    for (int j = 0; j < 4; ++j) { v[j] = tr[64 * j]; s += v[j].x * v[j].x + v[j].y * v[j].y + v[j].z * v[j].z + v[j].w * v[j].w; }
    const float rstd = 1.f / sqrtf(wave_sum(s) * (1.f / D) + EPS);
    float s2 = 0.f;
#pragma unroll
    for (int j = 0; j < 4; ++j) { v[j] = xr[64 * j] + v[j] * rstd * gr[64 * j]; s2 += v[j].x * v[j].x + v[j].y * v[j].y + v[j].z * v[j].z + v[j].w * v[j].w; }
    f32x4* orow = (f32x4*)(xo + (size_t)row * D) + lane;
#pragma unroll
    for (int j = 0; j < 4; ++j) orow[64 * j] = v[j];
    if (xn) {
        const float r2 = 1.f / sqrtf(wave_sum(s2) * (1.f / D) + EPS);
        unsigned long long* o8 = (unsigned long long*)(xn + (size_t)row * D) + lane;
#pragma unroll
        for (int j = 0; j < 4; ++j) o8[64 * j] = (unsigned long long)pk2(v[j].x * r2, v[j].y * r2) | ((unsigned long long)pk2(v[j].z * r2, v[j].w * r2) << 32);
    }
}

struct MapAdj { __device__ __forceinline__ int operator()(int p, int w) const { return 2 * p + w; } };
struct MapGU { __device__ __forceinline__ int operator()(int p, int w) const { return 256 * (p >> 7) + 128 * w + (p & 127); } };
struct EpiInProj {
    bf16* proj; const float2* rotm; const float2* rotr;
    __device__ __forceinline__ void operator()(int row, int p, float v0, float v1) const {
        const int col = 2 * p, s = row & (SEQ - 1), d = col & 63;
        float a = v0, b = v1;
        if (col < 1024) { if (d < 16) { const float2 cs = rotm[s * 8 + (d >> 1)]; a = v0 * cs.x - v1 * cs.y; b = v1 * cs.x + v0 * cs.y; } if (col < 512) { a *= C2M; b *= C2M; } }
        else if (col >= 1536 && col < 2048) { const float2 cs = rotr[s * 32 + (d >> 1)]; a = v0 * cs.x - v1 * cs.y; b = v1 * cs.x + v0 * cs.y; if (col >= 1792) { a *= 0.125f; b *= 0.125f; } }
        *(unsigned*)(proj + (size_t)row * NPROJ + col) = pk2(a, b);
    }
};
struct EpiPlain { bf16* out; int ldc; float scale;
    __device__ __forceinline__ void operator()(int row, int p, float v0, float v1) const { *(unsigned*)(out + (size_t)row * ldc + 2 * p) = pk2(v0 * scale, v1 * scale); } };
struct EpiF32 { float* out; int ldc; int pad;
    __device__ __forceinline__ void operator()(int row, int p, float v0, float v1) const { *(float2*)(out + (size_t)row * ldc + 2 * p) = make_float2(v0, v1); } };
struct EpiSwiglu { bf16* F;
    __device__ __forceinline__ void operator()(int row, int p, float v0, float v1) const { F[(size_t)row * DFF + p] = (bf16)f2bf(siluf(v0) * v1); } };

template <class Map, class Epi>
__global__ void __launch_bounds__(256) k_gemm(const bf16* __restrict__ A, const bf16* __restrict__ Bt, Epi epi, int K, int pad_) {
    const Map map{};
    __shared__ float As[32][65];
    __shared__ float Bs[32][65];
    const int t = threadIdx.x, tx = t & 15, ty = t >> 4;
    const int row0 = blockIdx.y * 64, p0 = blockIdx.x * 32;
    const int lr = t >> 2, kc = (t & 3) * 8;
    const bf16* ap = A + (size_t)(row0 + lr) * K + kc;
    const bf16* bp = Bt + (size_t)map(p0 + (lr >> 1), lr & 1) * K + kc;
    float acc[4][4];
#pragma unroll
    for (int i = 0; i < 4; ++i)
#pragma unroll
        for (int j = 0; j < 4; ++j) acc[i][j] = 0.f;
    for (int k0 = 0; k0 < K; k0 += 32) {
        const u32x4 av = *(const u32x4*)(ap + k0), bv = *(const u32x4*)(bp + k0);
#pragma unroll
        for (int j = 0; j < 4; ++j) { As[kc + 2 * j][lr] = bf2f(av[j] & 0xffffu); As[kc + 2 * j + 1][lr] = bf2f(av[j] >> 16); Bs[kc + 2 * j][lr] = bf2f(bv[j] & 0xffffu); Bs[kc + 2 * j + 1][lr] = bf2f(bv[j] >> 16); }
        __syncthreads();
#pragma unroll 8
        for (int k = 0; k < 32; ++k) {
            float a[4], b[4];
#pragma unroll
            for (int i = 0; i < 4; ++i) { a[i] = As[k][ty * 4 + i]; b[i] = Bs[k][tx * 4 + i]; }
#pragma unroll
            for (int i = 0; i < 4; ++i)
#pragma unroll
                for (int j = 0; j < 4; ++j) acc[i][j] += a[i] * b[j];
        }
        __syncthreads();
    }
#pragma unroll
    for (int i = 0; i < 4; ++i)
#pragma unroll
        for (int j = 0; j < 2; ++j) epi(row0 + ty * 4 + i, p0 + tx * 2 + j, acc[i][2 * j], acc[i][2 * j + 1]);
}

__global__ void k_kmean(const bf16* __restrict__ proj, float* __restrict__ kmean) {
    const int bhn = blockIdx.x, n = bhn & 7, h = (bhn >> 3) & 7, b = bhn >> 6, d = threadIdx.x;
    const bf16* kp = proj + (size_t)(b * SEQ + n * 256) * NPROJ + 512 + h * 64 + d;
    float s = 0.f;
    for (int j = 0; j < 256; ++j) s += bf2f(kp[(size_t)j * NPROJ]);
    kmean[bhn * 64 + d] = s * (1.f / 256.f);
}
__global__ void __launch_bounds__(256) k_moba(const bf16* __restrict__ proj, const float* __restrict__ kmean, bf16* __restrict__ mix) {
    const int w = blockIdx.x * 4 + (threadIdx.x >> 6), lane = threadIdx.x & 63;
    const int s = w & (SEQ - 1), h = (w >> 11) & 7, b = w >> 14;
    const int cur = s >> 8;
    const size_t row = (size_t)b * SEQ + s;
    const bf16* qp = proj + row * NPROJ + h * 64;
    const float qd = bf2f(qp[lane]);
    float gate[8];
#pragma unroll
    for (int n = 0; n < 8; ++n) gate[n] = (n < cur) ? wave_sum(qd * kmean[((b * 8 + h) * 8 + n) * 64 + lane]) : -3.0e38f;
    unsigned sel = 0;
    const int nsel = cur < 3 ? cur : 3;
    for (int k = 0; k < nsel; ++k) { int best = -1; float bv = -3.0e38f;
#pragma unroll
        for (int n = 0; n < 8; ++n) if (n < cur && !((sel >> n) & 1u) && (best < 0 || gate[n] > bv)) { best = n; bv = gate[n]; }
        sel |= 1u << best; }
    sel |= 1u << cur;
    float sc[8][4]; float mx = -3.0e38f;
#pragma unroll
    for (int n = 0; n < 8; ++n) {
#pragma unroll
        for (int jj = 0; jj < 4; ++jj) sc[n][jj] = -3.0e38f;
        if ((sel >> n) & 1u) {
#pragma unroll
            for (int jj = 0; jj < 4; ++jj) {
                const int j = n * 256 + jj * 64 + lane;
                const bf16* kp = proj + ((size_t)b * SEQ + j) * NPROJ + 512 + h * 64;
                float a = 0.f;
                for (int d = 0; d < 64; d += 8) { const u32x4 kv = *(const u32x4*)(kp + d);
#pragma unroll
                    for (int e = 0; e < 4; ++e) { a += __shfl(qd, d + 2 * e) * bf2f(kv[e] & 0xffffu) + __shfl(qd, d + 2 * e + 1) * bf2f(kv[e] >> 16); } }
                if (j <= s) { sc[n][jj] = a; mx = fmaxf(mx, a); }
            }
        }
    }
    mx = wave_max(mx);
    float l = 0.f;
#pragma unroll
    for (int n = 0; n < 8; ++n)
#pragma unroll
        for (int jj = 0; jj < 4; ++jj) { const float p = (sc[n][jj] > -1.0e38f) ? exp2f(sc[n][jj] - mx) : 0.f; sc[n][jj] = p; l += p; }
    l = wave_sum(l);
    float o = 0.f;
#pragma unroll
    for (int n = 0; n < 8; ++n) {
        if ((sel >> n) & 1u) {
#pragma unroll
            for (int jj = 0; jj < 4; ++jj) {
                const bf16* vp = proj + ((size_t)b * SEQ + n * 256 + jj * 64) * NPROJ + 1024 + h * 64 + lane;
                for (int jl = 0; jl < 64; ++jl) { const float p = __shfl(sc[n][jj], jl); o += p * bf2f(vp[(size_t)jl * NPROJ]); }
            }
        }
    }
    mix[row * D + h * 64 + lane] = (bf16)f2bf(o / l);
}

__global__ void __launch_bounds__(128) k_retention(const bf16* __restrict__ proj, bf16* __restrict__ mix) {
    __shared__ float qs[64];
    __shared__ float ss[SEQ];
    __shared__ float red[2];
    const int i = blockIdx.x & (SEQ - 1), h = (blockIdx.x >> 11) & 3, b = blockIdx.x >> 13, t = threadIdx.x;
    const size_t row = (size_t)b * SEQ + i;
    if (t < 64) qs[t] = bf2f(proj[row * NPROJ + 1536 + h * 64 + t]);
    __syncthreads();
    const float lg2 = log2f(1.f - exp2f(-5.f - (float)h));
    for (int j = t; j <= i; j += 128) {
        const bf16* kp = proj + ((size_t)b * SEQ + j) * NPROJ + 1792 + h * 64;
        float a = 0.f;
        for (int d = 0; d < 64; d += 8) { const u32x4 kv = *(const u32x4*)(kp + d);
#pragma unroll
            for (int e = 0; e < 4; ++e) a += qs[d + 2 * e] * bf2f(kv[e] & 0xffffu) + qs[d + 2 * e + 1] * bf2f(kv[e] >> 16); }
        ss[j] = a * exp2f(lg2 * (float)(i - j));
    }
    __syncthreads();
    const bf16* vp = proj + (size_t)b * SEQ * NPROJ + 2048 + h * 128 + t;
    float o = 0.f;
    for (int j = 0; j <= i; ++j) o += ss[j] * bf2f(vp[(size_t)j * NPROJ]);
    const float sq = wave_sum(o * o);
    if ((t & 63) == 0) red[t >> 6] = sq;
    __syncthreads();
    const float rstd = 1.f / sqrtf((red[0] + red[1]) * (1.f / 128.f) + EPS);
    const float g = bf2f(proj[row * NPROJ + 2560 + h * 128 + t]);
    mix[row * D + 512 + h * 128 + t] = (bf16)f2bf(siluf(g) * (o * rstd));
}

__global__ void __launch_bounds__(256) k_cross(const bf16* __restrict__ cq, const bf16* __restrict__ ck, const bf16* __restrict__ cvt, bf16* __restrict__ co) {
    __shared__ float qs[256];
    __shared__ float ps[256];
    __shared__ float red[4];
    const int row = blockIdx.x >> 2, h = blockIdx.x & 3, b = row >> 11, t = threadIdx.x;
    qs[t] = bf2f(cq[(size_t)row * D + h * 256 + t]);
    __syncthreads();
    const bf16* kp = ck + (size_t)(b * NMEM + t) * D + h * 256;
    float a = 0.f;
    for (int d = 0; d < 256; d += 8) { const u32x4 kv = *(const u32x4*)(kp + d);
#pragma unroll
        for (int e = 0; e < 4; ++e) a += qs[d + 2 * e] * bf2f(kv[e] & 0xffffu) + qs[d + 2 * e + 1] * bf2f(kv[e] >> 16); }
    float mx = wave_max(a);
    if ((t & 63) == 0) red[t >> 6] = mx;
    __syncthreads();
    mx = fmaxf(fmaxf(red[0], red[1]), fmaxf(red[2], red[3]));
    __syncthreads();
    const float p = exp2f(a - mx);
    ps[t] = p;
    const float sm = wave_sum(p);
    if ((t & 63) == 0) red[t >> 6] = sm;
    __syncthreads();
    const float l = (red[0] + red[1]) + (red[2] + red[3]);
    const bf16* vp = cvt + (size_t)(h * 256 + t) * MM + b * NMEM;
    float o = 0.f;
    for (int m = 0; m < 256; m += 8) { const u32x4 vv = *(const u32x4*)(vp + m);
#pragma unroll
        for (int e = 0; e < 4; ++e) o += ps[m + 2 * e] * bf2f(vv[e] & 0xffffu) + ps[m + 2 * e + 1] * bf2f(vv[e] >> 16); }
    co[(size_t)row * D + h * 256 + t] = (bf16)f2bf(o / l);
}

template <class Map, class Epi>
static void gemm(const bf16* A, const bf16* Bt, int Mr, int NP, int K, Map, Epi epi, hipStream_t st) {
    hipLaunchKernelGGL((k_gemm<Map, Epi>), dim3(NP / 32, Mr / 64), dim3(256), 0, st, A, Bt, epi, K, 0);
}
static void convert(const float* W, int K, int N, bf16* WT, int Nd, const float* gain, int mode, int off, hipStream_t st) {
    hipLaunchKernelGGL(k_convert_w, dim3(Nd / 32, K / 32), dim3(32, 8), 0, st, W, WT, gain, K, N, mode, off);
}

extern "C" void kernel_launch(void* const* d_in, const int* in_sizes, int n_in, void* d_out, int out_size, void* d_ws, size_t ws_size, hipStream_t stream) {
    if (n_in != 16 || out_size != M * D || ws_size < WS_END) { fprintf(stderr, "kernel_launch: unexpected shapes (n_in %d out %d ws %zu)\n", n_in, out_size, ws_size); return; }
    const float* x = (const float*)d_in[0]; const float* mem = (const float*)d_in[1];
    const float* g_pre_mix = (const float*)d_in[2]; const float* w_in = (const float*)d_in[3]; const float* w_out = (const float*)d_in[4];
    const float* g_post_mix = (const float*)d_in[5]; const float* g_pre_cross = (const float*)d_in[6]; const float* g_mem = (const float*)d_in[7];
    const float* w_cq = (const float*)d_in[8]; const float* w_ckv = (const float*)d_in[9]; const float* w_co = (const float*)d_in[10];
    const float* g_post_cross = (const float*)d_in[11]; const float* g_pre_ffn = (const float*)d_in[12]; const float* w_gu = (const float*)d_in[13];
    const float* w_dn = (const float*)d_in[14]; const float* g_post_ffn = (const float*)d_in[15];
    float* out = (float*)d_out; unsigned char* ws = (unsigned char*)d_ws;
    float2* rotm = (float2*)(ws + WS_ROTM); float2* rotr = (float2*)(ws + WS_ROTR); float* kmean = (float*)(ws + WS_KMEAN);
    bf16 *Win = (bf16*)(ws + WS_WIN), *Wout = (bf16*)(ws + WS_WOUT), *Wcq = (bf16*)(ws + WS_WCQ), *Wck = (bf16*)(ws + WS_WCK), *Wcv = (bf16*)(ws + WS_WCV), *Wco = (bf16*)(ws + WS_WCO), *Wgu = (bf16*)(ws + WS_WGU), *Wdn = (bf16*)(ws + WS_WDN);
    bf16 *MEMN = (bf16*)(ws + WS_MEMN), *CK = (bf16*)(ws + WS_CK), *CVT = (bf16*)(ws + WS_CVT), *XN = (bf16*)(ws + WS_XN), *MIX = (bf16*)(ws + WS_MIX);
    bf16 *PROJ = (bf16*)(ws + WS_PROJ), *CQ = (bf16*)(ws + WS_CQ), *CO = (bf16*)(ws + WS_CO), *F = (bf16*)(ws + WS_F);
    float* T1 = (float*)(ws + WS_A);
    float* T2 = (float*)(ws + WS_XN);

    hipLaunchKernelGGL(k_tables, dim3(SEQ * 32 / 256), dim3(256), 0, stream, rotm, rotr);
    convert(w_in, D, NPROJ, Win, NPROJ, g_pre_mix, MAP_INPROJ, 0, stream);
    convert(w_out, D, D, Wout, D, nullptr, MAP_ID, 0, stream);
    convert(w_cq, D, D, Wcq, D, g_pre_cross, MAP_ID, 0, stream);
    convert(w_ckv, D, 2 * D, Wck, D, g_mem, MAP_ID, 0, stream);
    convert(w_ckv, D, 2 * D, Wcv, D, g_mem, MAP_ID, D, stream);
    convert(w_co, D, D, Wco, D, nullptr, MAP_ID, 0, stream);
    convert(w_gu, D, NGU, Wgu, NGU, g_pre_ffn, MAP_GU, 0, stream);
    convert(w_dn, DFF, D, Wdn, D, nullptr, MAP_ID, 0, stream);
    hipLaunchKernelGGL(k_rmsnorm_bf16, dim3(M / 4), dim3(256), 0, stream, x, XN, M, 0);
    hipLaunchKernelGGL(k_rmsnorm_bf16, dim3(MM / 4), dim3(256), 0, stream, mem, MEMN, MM, 0);
    gemm(XN, Win, M, NPROJ / 2, D, MapAdj{}, EpiInProj{PROJ, rotm, rotr}, stream);
    hipLaunchKernelGGL(k_kmean, dim3(512), dim3(64), 0, stream, PROJ, kmean);
    hipLaunchKernelGGL(k_moba, dim3(BATCH * 8 * SEQ / 4), dim3(256), 0, stream, PROJ, kmean, MIX);
    hipLaunchKernelGGL(k_retention, dim3(BATCH * 4 * SEQ), dim3(128), 0, stream, PROJ, MIX);
    gemm(MIX, Wout, M, D / 2, D, MapAdj{}, EpiF32{T1, D, 0}, stream);
    hipLaunchKernelGGL(k_postnorm, dim3(M / 4), dim3(256), 0, stream, T1, x, g_post_mix, out, XN, M, 0);
    gemm(MEMN, Wck, MM, D / 2, D, MapAdj{}, EpiPlain{CK, D, 1.f}, stream);
    gemm(Wcv, MEMN, D, MM / 2, D, MapAdj{}, EpiPlain{CVT, MM, 1.f}, stream);
    gemm(XN, Wcq, M, D / 2, D, MapAdj{}, EpiPlain{CQ, D, C2X}, stream);
    hipLaunchKernelGGL(k_cross, dim3(M * 4), dim3(256), 0, stream, CQ, CK, CVT, CO);
    gemm(CO, Wco, M, D / 2, D, MapAdj{}, EpiF32{T1, D, 0}, stream);
    hipLaunchKernelGGL(k_postnorm, dim3(M / 4), dim3(256), 0, stream, T1, out, g_post_cross, out, XN, M, 0);
    gemm(XN, Wgu, M, DFF, D, MapGU{}, EpiSwiglu{F}, stream);
    gemm(F, Wdn, M, D / 2, DFF, MapAdj{}, EpiF32{T2, D, 0}, stream);
    hipLaunchKernelGGL(k_postnorm, dim3(M / 4), dim3(256), 0, stream, T2, out, g_post_ffn, out, (bf16*)nullptr, M, 0);
}
```
